# Optimizing an MI355X kernel written in HIP

```python
import jax, jax.numpy as jnp
from jax import lax
import numpy as np

D_MODEL = 1024
BATCH = 4
SEQ = 4096
DEPTH = 1

HEAD_DIM = 64
HEADS_PER_GROUP = D_MODEL // 128
ATT_GROUPS = ((128, 1), (512, 4), (2048, 16))
N_ATT_GROUPS = len(ATT_GROUPS)
N_ATT_HEADS = N_ATT_GROUPS * HEADS_PER_GROUP
ATT_WIDTH = N_ATT_HEADS * HEAD_DIM
ATT_OUT_WIDTH = HEADS_PER_GROUP * HEAD_DIM
ROT_DIM = HEAD_DIM // 4
ROPE_THETA = 500000.0
Q_BLOCK = 128
POOL_WINDOWS = (2, 4, 8, 16)
POOL_GROUPS = len(POOL_WINDOWS)
POOL_GROUP_WIDTH = D_MODEL // 8
POOL_WIDTH = POOL_GROUPS * POOL_GROUP_WIDTH
IN_WIDTH = 3 * ATT_WIDTH + POOL_WIDTH + 2 * D_MODEL
D_FF = -(-8 * D_MODEL // (3 * 256)) * 256
NORM_EPS = 1e-6

kernel_name = "hybrid_dilated_attn_pool_gated_block"


def rms_norm(x, g):
    xf = x.astype(jnp.float32)
    y = xf * lax.rsqrt(jnp.mean(xf * xf, axis=-1, keepdims=True) + NORM_EPS)
    return (y * g.astype(jnp.float32)).astype(x.dtype)


def partial_rope(x, pos):
    half = ROT_DIM // 2
    inv_freq = ROPE_THETA ** (-jnp.arange(0, ROT_DIM, 2, dtype=jnp.float32) / ROT_DIM)
    ang = pos.astype(jnp.float32)[:, None] * inv_freq[None, :]
    cos = jnp.cos(ang)[None, :, None, :]
    sin = jnp.sin(ang)[None, :, None, :]
    xr = x[..., :ROT_DIM].astype(jnp.float32)
    x1, x2 = xr[..., :half], xr[..., half:]
    rot = jnp.concatenate([x1 * cos - x2 * sin, x2 * cos + x1 * sin], axis=-1)
    return jnp.concatenate([rot.astype(x.dtype), x[..., ROT_DIM:]], axis=-1)


def dilated_attention(q, k, v):
    B, S = q.shape[0], q.shape[1]
    n_blocks = S // Q_BLOCK
    scale = HEAD_DIM ** -0.5
    k_pad = [jnp.pad(k[:, :, g], ((0, 0), (w, 0), (0, 0), (0, 0))) for g, (w, _) in enumerate(ATT_GROUPS)]
    v_pad = [jnp.pad(v[:, :, g], ((0, 0), (w, 0), (0, 0), (0, 0))) for g, (w, _) in enumerate(ATT_GROUPS)]
    q_blocks = q.reshape(B, n_blocks, Q_BLOCK, N_ATT_GROUPS, HEADS_PER_GROUP, HEAD_DIM).transpose(1, 0, 2, 3, 4, 5)

    def block_fn(args):
        n, q_blk = args
        start = n * Q_BLOCK
        qi = jnp.arange(Q_BLOCK)
        outs, lses = [], []
        for g, (w, d) in enumerate(ATT_GROUPS):
            n_keys = w // d + 1
            offs = d * jnp.arange(n_keys)
            idx = qi[:, None] + w - offs[None, :]
            band_k = lax.dynamic_slice_in_dim(k_pad[g], start, Q_BLOCK + w, axis=1)
            band_v = lax.dynamic_slice_in_dim(v_pad[g], start, Q_BLOCK + w, axis=1)
            kg = band_k[:, idx]
            vg = band_v[:, idx]
            valid = ((start + qi)[:, None] - offs[None, :]) >= 0
            s = jnp.einsum('bqhd,bqkhd->bhqk', q_blk[:, :, g], kg,
                           preferred_element_type=jnp.float32) * scale
            s = jnp.where(valid, s, -jnp.inf)
            m = jnp.max(s, axis=-1, keepdims=True)
            p = jnp.exp(s - m)
            l = jnp.sum(p, axis=-1, keepdims=True)
            o = jnp.einsum('bhqk,bqkhd->bhqd', p, vg.astype(jnp.float32)) / l
            outs.append(o)
            lses.append((m + jnp.log(l))[..., 0])
        alpha = jax.nn.softmax(jnp.stack(lses, axis=0), axis=0)
        o = jnp.sum(alpha[..., None] * jnp.stack(outs, axis=0), axis=0)
        return o.transpose(0, 2, 1, 3).astype(q_blk.dtype)

    out = lax.map(block_fn, (jnp.arange(n_blocks), q_blocks))
    return out.transpose(1, 0, 2, 3, 4).reshape(B, S, ATT_OUT_WIDTH)


def multiscale_pool(z):
    B, S = z.shape[0], z.shape[1]
    zf = z.astype(jnp.float32).reshape(B, S, POOL_GROUPS, POOL_GROUP_WIDTH)
    csum = jnp.concatenate([jnp.zeros_like(zf[:, :1]), jnp.cumsum(zf, axis=1)], axis=1)
    outs = []
    for g, w in enumerate(POOL_WINDOWS):
        cg = csum[:, :, g]
        lower = jnp.concatenate([jnp.zeros_like(cg[:, :w - 1]), cg[:, :S + 1 - w]], axis=1)
        count = jnp.minimum(jnp.arange(1, S + 1), w).astype(jnp.float32)
        outs.append((cg[:, 1:] - lower) / count[None, :, None] - zf[:, :, g])
    return jnp.stack(outs, axis=2)


def setup_inputs(seed: int = 0) -> dict:
    key = jax.random.key(seed)
    ks = jax.random.split(key, 16)
    f32 = jnp.float32

    def dense(k, shape, fan_in):
        return jax.random.normal(k, shape, f32) * (fan_in ** -0.5)

    def gain(k, shape):
        return jnp.ones(shape, f32) + 0.02 * jax.random.normal(k, shape, f32)

    return {
        "x": jax.random.normal(ks[0], (BATCH, SEQ, D_MODEL), f32),
        "norm_mix": gain(ks[1], (DEPTH, D_MODEL)),
        "w_in": dense(ks[2], (DEPTH, D_MODEL, IN_WIDTH), D_MODEL),
        "w_pool_group": dense(ks[3], (DEPTH, POOL_GROUPS, POOL_GROUP_WIDTH, POOL_GROUP_WIDTH), POOL_GROUP_WIDTH),
        "pool_scale": gain(ks[4], (DEPTH, POOL_WIDTH)),
        "w_att_branch": dense(ks[5], (DEPTH, ATT_OUT_WIDTH, D_MODEL), ATT_OUT_WIDTH),
        "w_pool_branch": dense(ks[6], (DEPTH, POOL_WIDTH, D_MODEL), POOL_WIDTH),
        "w_out": dense(ks[7], (DEPTH, D_MODEL, D_MODEL), D_MODEL),
        "norm_ffn": gain(ks[8], (DEPTH, D_MODEL)),
        "w_ffn_gate": dense(ks[9], (DEPTH, D_MODEL, D_FF), D_MODEL),
        "w_ffn_up": dense(ks[10], (DEPTH, D_MODEL, D_FF), D_MODEL),
        "w_ffn_down": dense(ks[11], (DEPTH, D_FF, D_MODEL), D_FF),
        "norm_final": gain(ks[12], (D_MODEL,)),
    }


def reference(x, norm_mix, w_in, w_pool_group, pool_scale, w_att_branch, w_pool_branch,
              w_out, norm_ffn, w_ffn_gate, w_ffn_up, w_ffn_down, norm_final):
    B, S, _ = x.shape
    pos = jnp.arange(S)
    h = x
    for l in range(DEPTH):
        u = rms_norm(h, norm_mix[l])
        proj = u @ w_in[l]
        q, k, v, z, g_att, g_pool = jnp.split(
            proj, np.cumsum([ATT_WIDTH, ATT_WIDTH, ATT_WIDTH, POOL_WIDTH, D_MODEL]).tolist(), axis=-1)
        q = partial_rope(q.reshape(B, S, N_ATT_HEADS, HEAD_DIM), pos)
        k = partial_rope(k.reshape(B, S, N_ATT_HEADS, HEAD_DIM), pos)
        grp = (B, S, N_ATT_GROUPS, HEADS_PER_GROUP, HEAD_DIM)
        att = dilated_attention(q.reshape(grp), k.reshape(grp), v.reshape(grp))
        pooled = multiscale_pool(z)
        pooled = jnp.einsum('bsgc,gce->bsge', pooled, w_pool_group[l].astype(jnp.float32))
        pooled = (pooled.reshape(B, S, POOL_WIDTH) * pool_scale[l].astype(jnp.float32)).astype(h.dtype)
        y_att = att @ w_att_branch[l]
        y_pool = pooled @ w_pool_branch[l]
        merged = jax.nn.sigmoid(g_att) * y_att + jax.nn.sigmoid(g_pool) * y_pool
        h = h + merged @ w_out[l]
        f = rms_norm(h, norm_ffn[l])
        h = h + (jax.nn.silu(f @ w_ffn_gate[l]) * (f @ w_ffn_up[l])) @ w_ffn_down[l]
    return rms_norm(h, norm_final)
```

```cpp
#include <hip/hip_runtime.h>
#include <cstdio>
#include <cstdint>
namespace pg8 {
#define PG8_LAS __attribute__((address_space(3)))
typedef unsigned short bf16_t;
typedef short bf16x8 __attribute__((ext_vector_type(8)));
typedef float f32x4 __attribute__((ext_vector_type(4)));
typedef unsigned u32x4 __attribute__((ext_vector_type(4)));
constexpr int BM = 256, BK = 64, HALF = 128, HTB = HALF * BK * 2  , STAGE_BYTES = 8 * HTB, NXCD = 8, WGM = 8;

__host__ __device__ __forceinline__ int lds_byte(int r, int c) { const int st = (r >> 4) * 2 + (c >> 5), rr = r & 15, cc = c & 31, ob = rr * 64 + cc * 2; return st * 1024 + (ob ^ (((ob >> 9) & 1) << 5)); }
__host__ __device__ __forceinline__ void stage_rc(int b, int& R, int& C) { const int st = b / 1024, sb = b % 1024, swz = sb ^ (((sb >> 9) & 1) << 5); R = (st >> 1) * 16 + swz / 64; C = (st & 1) * 32 + (swz % 64) / 2; }
__host__ __device__ __forceinline__ int perm32(int rho) { const int n = rho >> 4, i = rho & 15; return 8 * (i >> 2) + 4 * n + (i & 3); }

struct Unit { int pm, pn; };
struct Gemm { const bf16_t* A; const bf16_t* Bt; int M, N, K; };

struct StaticOrder {
    int nM, nN, nwg, G, c;
    __host__ __device__ void init(int M, int N, int G_, int c_) { nM = M / BM; nN = N / BM; nwg = nM * nN; G = G_; c = c_; }
    __host__ __device__ bool next(int i, Unit& u) const {
        const long L = (long)i * G + c; if (L >= nwg) return false;
        int wgid = (int)L; { const int q = nwg / NXCD, r = nwg % NXCD, xcd = wgid % NXCD, off = wgid / NXCD; wgid = (xcd < r ? xcd * (q + 1) : r * (q + 1) + (xcd - r) * q) + off; }
        const int nig = WGM * nN, gid = wgid / nig, fm = gid * WGM, gsz = (nM - fm) < WGM ? (nM - fm) : WGM;
        u.pm = fm + ((wgid % nig) % gsz); u.pn = (wgid % nig) / gsz; return true;
    }
    __device__ __forceinline__ void a_ready(const Unit&) const {}
    __device__ __forceinline__ void done(const Unit&) const {}
};
__device__ __forceinline__ unsigned cvt_pk_bf16(float lo, float hi) { unsigned r; asm volatile("v_cvt_pk_bf16_f32 %0, %1, %2" : "=v"(r) : "v"(lo), "v"(hi)); return r; }
typedef float f32x2 __attribute__((ext_vector_type(2)));
typedef unsigned u32x2 __attribute__((ext_vector_type(2)));
__device__ __forceinline__ float sigm(float x) { return __builtin_amdgcn_rcpf(1.0f + __builtin_amdgcn_exp2f(-1.4426950408889634f * x)); }
__device__ __forceinline__ u32x4 pack8(const f32x4 v0, const f32x4 v1) { u32x4 w; w.x = cvt_pk_bf16(v0[0], v0[1]); w.y = cvt_pk_bf16(v0[2], v0[3]); w.z = cvt_pk_bf16(v1[0], v1[1]); w.w = cvt_pk_bf16(v1[2], v1[3]); return w; }
__device__ __forceinline__ void unpack8(const u32x4 w, f32x4& v0, f32x4& v1) {
    v0[0] = __uint_as_float(w.x << 16); v0[1] = __uint_as_float(w.x & 0xffff0000u); v0[2] = __uint_as_float(w.y << 16); v0[3] = __uint_as_float(w.y & 0xffff0000u);
    v1[0] = __uint_as_float(w.z << 16); v1[1] = __uint_as_float(w.z & 0xffff0000u); v1[2] = __uint_as_float(w.w << 16); v1[3] = __uint_as_float(w.w & 0xffff0000u); }

struct EpiP1 {
    static constexpr bool PERM = true, AFTER_DRAIN = false;
    bf16_t *Q, *K, *V, *ZZ, *GA, *GP; const float* cs; float qscale;
    __device__ __forceinline__ void operator()(const f32x4 (&acc)[2][2][4][2], const Unit& u, int wr, int wc, int fr, int fq) const {
        const int row0 = u.pm * BM + wr * 64 + fr, cw = wc * 32 + 8 * fq, pn = u.pn;
        if (pn < 12) {
            const bool isq = pn < 6; bf16_t* dst = isq ? Q : K; const int colt = (isq ? pn : pn - 6) * BM; const float sc = isq ? qscale : 1.0f;
            const bool ropew = (wc & 1) == 0;
            const bool ropel = fq < 2;
            const float sgn = fq == 0 ? -1.0f : 1.0f;
#pragma unroll
            for (int ai = 0; ai < 2; ++ai)
#pragma unroll
                for (int m = 0; m < 4; ++m) {
                    const int row = row0 + ai * HALF + m * 16, pos = row & 4095;
                    f32x4 c0 = {1.f, 1.f, 1.f, 1.f}, c1 = c0, s0 = {0.f, 0.f, 0.f, 0.f}, s1 = s0;
                    if (ropew) { const f32x4* t = (const f32x4*)(cs + pos * 16); c0 = t[0]; c1 = t[1]; s0 = t[2]; s1 = t[3]; }
                    bf16_t* rowp = dst + (size_t)row * 1536 + colt + cw;
#pragma unroll
                    for (int bj = 0; bj < 2; ++bj) {
                        f32x4 v0 = acc[ai][bj][m][0], v1 = acc[ai][bj][m][1];
                        if (ropew) {
                            f32x4 p0, p1;
#pragma unroll
                            for (int e = 0; e < 4; ++e) { p0[e] = __shfl_xor(v0[e], 16); p1[e] = __shfl_xor(v1[e], 16); }
                            if (ropel) { v0 = v0 * c0 + sgn * (p0 * s0); v1 = v1 * c1 + sgn * (p1 * s1); }
                        }
                        v0 = v0 * sc; v1 = v1 * sc;
                        *(u32x4*)(rowp + bj * HALF) = pack8(v0, v1);
                    }
                }
        } else if (pn < 20) {
            const bool isv = pn < 18; bf16_t* dst = isv ? V : ZZ; const int pitch = isv ? 1536 : 512; const int colt = (isv ? pn - 12 : pn - 18) * BM;
#pragma unroll
            for (int ai = 0; ai < 2; ++ai)
#pragma unroll
                for (int m = 0; m < 4; ++m) { bf16_t* rowp = dst + (size_t)(row0 + ai * HALF + m * 16) * pitch + colt + cw;
#pragma unroll
                    for (int bj = 0; bj < 2; ++bj) *(u32x4*)(rowp + bj * HALF) = pack8(acc[ai][bj][m][0], acc[ai][bj][m][1]); }
        } else {
            bf16_t* dst = pn < 24 ? GA : GP; const int colt = ((pn - 20) & 3) * BM;
#pragma unroll
            for (int ai = 0; ai < 2; ++ai)
#pragma unroll
                for (int m = 0; m < 4; ++m) { bf16_t* rowp = dst + (size_t)(row0 + ai * HALF + m * 16) * 1024 + colt + cw;
#pragma unroll
                    for (int bj = 0; bj < 2; ++bj) { f32x4 v0 = acc[ai][bj][m][0], v1 = acc[ai][bj][m][1];
#pragma unroll
                        for (int e = 0; e < 4; ++e) { v0[e] = sigm(v0[e]); v1[e] = sigm(v1[e]); }
                        *(u32x4*)(rowp + bj * HALF) = pack8(v0, v1); } }
        }
    }
};

struct EpiP3 {
    static constexpr bool PERM = true, AFTER_DRAIN = false;
    const bf16_t *GA, *GP; float* T1; bf16_t* MG;
    __device__ __forceinline__ void operator()(const f32x4 (&acc)[2][2][4][2], const Unit& u, int wr, int wc, int fr, int fq) const {
        const int half = u.pn >> 2, pm = u.pm & 63, pn = u.pn & 3;
        const int row0 = pm * BM + wr * 64 + fr, col0 = pn * BM + wc * 32 + 8 * fq;
        const bf16_t* G = half ? GP : GA;
#pragma unroll
        for (int ai = 0; ai < 2; ++ai)
#pragma unroll
            for (int m = 0; m < 4; ++m) { const size_t offr = (size_t)(row0 + ai * HALF + m * 16) * 1024 + col0;
#pragma unroll
                for (int bj = 0; bj < 2; ++bj) { const size_t off = offr + bj * HALF;
                    f32x4 g0, g1; unpack8(*(const u32x4*)(G + off), g0, g1);
                    f32x4 v0 = acc[ai][bj][m][0] * g0, v1 = acc[ai][bj][m][1] * g1;
                    if (half == 0) { *(f32x4*)(T1 + off) = v0; *(f32x4*)(T1 + off + 4) = v1; }
                    else { v0 = v0 + *(const f32x4*)(T1 + off); v1 = v1 + *(const f32x4*)(T1 + off + 4); *(u32x4*)(MG + off) = pack8(v0, v1); } } }
    }
};

template <bool WBF> struct EpiRes {
    static constexpr bool PERM = true, AFTER_DRAIN = true;
    const float* base; float* out; bf16_t* ob; float* ssq;
    __device__ __forceinline__ void fused(f32x4 (&acc)[2][2][4][2], const Unit& u, int wr, int wc, int fr, int fq, PG8_LAS unsigned char* lds, int wid, int lane) const {
        PG8_LAS float* P = (PG8_LAS float*)lds;
        const int row0 = u.pm * BM + wr * 64 + fr, col0 = u.pn * BM + wc * 32 + 8 * fq;
#pragma unroll
        for (int ai = 0; ai < 2; ++ai)
#pragma unroll
            for (int m = 0; m < 4; ++m) { const size_t offr = (size_t)(row0 + ai * HALF + m * 16) * 1024 + col0; float ss = 0.f;
#pragma unroll
                for (int bj = 0; bj < 2; ++bj) { const size_t off = offr + bj * HALF;
                    const f32x4 h0 = *(const f32x4*)(base + off) + acc[ai][bj][m][0], h1 = *(const f32x4*)(base + off + 4) + acc[ai][bj][m][1];
                    *(f32x4*)(out + off) = h0; *(f32x4*)(out + off + 4) = h1;
                    if (WBF) *(u32x4*)(ob + off) = pack8(h0, h1);
                    ss += (h0[0] * h0[0] + h0[1] * h0[1]) + (h0[2] * h0[2] + h0[3] * h0[3]) + (h1[0] * h1[0] + h1[1] * h1[1]) + (h1[2] * h1[2] + h1[3] * h1[3]); }
                ss += __shfl_xor(ss, 16); ss += __shfl_xor(ss, 32);
                if (fq == 0) P[(ai * HALF + wr * 64 + m * 16 + fr) * 4 + wc] = ss; }
        asm volatile("s_waitcnt lgkmcnt(0)" ::: "memory"); __builtin_amdgcn_s_barrier(); asm volatile("" ::: "memory");
        const int t = wid * 64 + lane;
        if (t < 256) { const f32x4 v = *(const PG8_LAS f32x4*)(P + t * 4); ssq[(size_t)(u.pm * BM + t) * 4 + u.pn] = (v[0] + v[1]) + (v[2] + v[3]); }
    }
};

struct EpiP5 {
    static constexpr bool PERM = true, AFTER_DRAIN = false;
    const float* ssq; bf16_t* ACT; float eps;
    __device__ __forceinline__ void operator()(const f32x4 (&acc)[2][2][4][2], const Unit& u, int wr, int wc, int fr, int fq) const {
        const int row0 = u.pm * BM + wr * 64 + fr, col0 = u.pn * HALF + wc * 32 + 8 * fq;
#pragma unroll
        for (int ai = 0; ai < 2; ++ai)
#pragma unroll
            for (int m = 0; m < 4; ++m) { const int row = row0 + ai * HALF + m * 16;
                const f32x4 s = *(const f32x4*)(ssq + (size_t)row * 4);
                const float rstd = __builtin_amdgcn_rsqf(((s[0] + s[1]) + (s[2] + s[3])) * (1.0f / 1024.0f) + eps);
                f32x4 o0, o1;
#pragma unroll
                for (int e = 0; e < 4; ++e) { const float g0 = acc[ai][0][m][0][e] * rstd, u0 = acc[ai][1][m][0][e] * rstd, g1 = acc[ai][0][m][1][e] * rstd, u1 = acc[ai][1][m][1][e] * rstd;
                    o0[e] = g0 * sigm(g0) * u0; o1[e] = g1 * sigm(g1) * u1; }
                *(u32x4*)(ACT + (size_t)row * 2816 + col0) = pack8(o0, o1); }
    }
};

struct P3Order {
    StaticOrder so;
    __device__ __forceinline__ bool next(int i, Unit& u) const { if (i >= 2) return false; Unit b; if (!so.next(0, b)) return false; u.pm = b.pm + 64 * i; u.pn = b.pn + 4 * i; return true; }
    __device__ __forceinline__ void a_ready(const Unit&) const {}
    __device__ __forceinline__ void done(const Unit&) const {}
};

template <class Epi, class Sched, bool ALIGN_EPI = false, bool SP2 = false>
__device__ __forceinline__ void gemm_phase(PG8_LAS unsigned char* lds, const Gemm g, const Sched& S, const Epi& E) {
    const int tid = threadIdx.x, wid = __builtin_amdgcn_readfirstlane(tid >> 6), lane = tid & 63, wr = wid >> 2, wc = wid & 3, fr = lane & 15, fq = lane >> 4;
    const int K = g.K, nt = K / BK;
    unsigned voffA[2], voffB[2];
#pragma unroll
    for (int i = 0; i < 2; ++i) { int R, C; stage_rc(tid * 16 + i * 8192, R, C); const int Rb = Epi::PERM ? ((R & ~31) + perm32(R & 31)) : R;
        voffA[i] = (unsigned)(R * K + C) * 2u; voffB[i] = (unsigned)(Rb * K + C) * 2u; }
    const size_t kstep = (size_t)(BK * 2);
    const size_t hstep = (size_t)HALF * K * 2;
    const size_t tstep = 2 * hstep;
    const unsigned ldsw = (unsigned)wid * 1024u;
    const int aoff = lds_byte(wr * 64 + fr, fq * 8), boff = lds_byte(wc * 32 + fr, fq * 8);
#define PG8_SA(b, h) (((b) * 2 + (h)) * HTB)
#define PG8_SB(b, h) ((4 + (b) * 2 + (h)) * HTB)
#define PG8_STAGE(bufoff, gbase, voff) do { _Pragma("unroll") for (int _i = 0; _i < 2; ++_i) \
        __builtin_amdgcn_global_load_lds((const unsigned*)((const char*)(gbase) + (voff)[_i]), (PG8_LAS unsigned*)(lds + (bufoff) + ldsw + _i * 8192), 16, 0, 0); } while (0)
#define PG8_LDA(dst, b, h) do { _Pragma("unroll") for (int m = 0; m < 4; ++m) _Pragma("unroll") for (int k = 0; k < 2; ++k) dst[m][k] = *(const PG8_LAS bf16x8*)(lds + PG8_SA(b, h) + aoff + m * 2048 + k * 1024); } while (0)
#define PG8_LDB(dst, b, h) do { _Pragma("unroll") for (int n = 0; n < 2; ++n) _Pragma("unroll") for (int k = 0; k < 2; ++k) dst[n][k] = *(const PG8_LAS bf16x8*)(lds + PG8_SB(b, h) + boff + n * 2048 + k * 1024); } while (0)
#define PG8_MMA(ai, bj, At, Bt) do { __builtin_amdgcn_s_setprio(1); _Pragma("unroll") for (int m = 0; m < 4; ++m) _Pragma("unroll") for (int n = 0; n < 2; ++n) _Pragma("unroll") for (int k = 0; k < 2; ++k) \
        acc[ai][bj][m][n] = __builtin_amdgcn_mfma_f32_16x16x32_bf16(Bt[n][k], At[m][k], acc[ai][bj][m][n], 0, 0, 0); __builtin_amdgcn_s_setprio(0); } while (0)
#define PG8_WAIT_V(n) asm volatile("s_waitcnt vmcnt(" #n ")" ::: "memory")
#define PG8_WAIT_L(n) asm volatile("s_waitcnt lgkmcnt(" #n ")" ::: "memory")
#define PG8_BAR __builtin_amdgcn_s_barrier()
#define PG8_SCHED __builtin_amdgcn_sched_barrier(0)
    Unit cur, nxt; int ui = 0;
    if (!S.next(0, cur)) return;
    f32x4 acc[2][2][4][2];
#pragma unroll
    for (int a = 0; a < 2; ++a)
#pragma unroll
        for (int b = 0; b < 2; ++b)
#pragma unroll
            for (int m = 0; m < 4; ++m)
#pragma unroll
                for (int n = 0; n < 2; ++n) acc[a][b][m][n] = (f32x4){0.f, 0.f, 0.f, 0.f};
    bf16x8 At[4][2], B0[2][2], B1[2][2];
    const char* cA = (const char*)g.A + (size_t)cur.pm * tstep; const char* cB = (const char*)g.Bt + (size_t)cur.pn * tstep;
    S.a_ready(cur);
    if constexpr (SP2) {
        PG8_STAGE(PG8_SB(0, 0), cB, voffB); PG8_STAGE(PG8_SB(0, 1), cB + hstep, voffB); PG8_STAGE(PG8_SA(0, 0), cA, voffA); PG8_STAGE(PG8_SA(0, 1), cA + hstep, voffA);
        if (wr == 1) PG8_BAR;
        PG8_WAIT_V(2); PG8_BAR;
        PG8_STAGE(PG8_SB(1, 0), cB + kstep, voffB); PG8_STAGE(PG8_SA(1, 0), cA + kstep, voffA); PG8_STAGE(PG8_SB(1, 1), cB + hstep + kstep, voffB);
        PG8_WAIT_V(6); PG8_BAR;
    } else {
        PG8_STAGE(PG8_SB(0, 0), cB, voffB); PG8_STAGE(PG8_SA(0, 0), cA, voffA); PG8_STAGE(PG8_SB(0, 1), cB + hstep, voffB); PG8_STAGE(PG8_SA(0, 1), cA + hstep, voffA);
        if (wr == 1) PG8_BAR;
        PG8_WAIT_V(4); PG8_BAR;
        PG8_STAGE(PG8_SB(1, 0), cB + kstep, voffB); PG8_STAGE(PG8_SA(1, 0), cA + kstep, voffA); PG8_STAGE(PG8_SB(1, 1), cB + hstep + kstep, voffB);
        PG8_WAIT_V(6); PG8_BAR;
    }
    for (;;) {
        const bool has_next = S.next(ui + 1, nxt);
        const char* nA = has_next ? (const char*)g.A + (size_t)nxt.pm * tstep : cA; const char* nB = has_next ? (const char*)g.Bt + (size_t)nxt.pn * tstep : cB;
        for (int t = 0; t < nt; t += 2) {
            const bool last = (t == nt - 2);
            const char* a1 = cA + (size_t)(t + 1) * kstep;
            const char* a2 = last ? nA : cA + (size_t)(t + 2) * kstep; const char* b2 = last ? nB : cB + (size_t)(t + 2) * kstep;
            const char* a3 = a2 + kstep; const char* b3 = b2 + kstep;
            if (last && has_next) S.a_ready(nxt);
            if constexpr (SP2) {
            PG8_LDB(B0, 0, 0); PG8_LDB(B1, 0, 1); PG8_SCHED; PG8_LDA(At, 0, 0); PG8_STAGE(PG8_SA(1, 1), a1 + hstep, voffA);
            PG8_WAIT_V(8); PG8_WAIT_L(0); PG8_BAR; PG8_MMA(0, 0, At, B0); PG8_MMA(0, 1, At, B1); PG8_BAR; PG8_SCHED;
            PG8_LDA(At, 0, 1); PG8_STAGE(PG8_SB(0, 0), b2, voffB); PG8_STAGE(PG8_SB(0, 1), b2 + hstep, voffB); PG8_STAGE(PG8_SA(0, 0), a2, voffA);
            PG8_WAIT_V(8); PG8_WAIT_L(0); PG8_BAR; PG8_MMA(1, 0, At, B0); PG8_MMA(1, 1, At, B1); PG8_BAR; PG8_SCHED;
            PG8_LDB(B0, 1, 0); PG8_LDB(B1, 1, 1); PG8_SCHED; PG8_LDA(At, 1, 0); PG8_STAGE(PG8_SA(0, 1), a2 + hstep, voffA);
            PG8_WAIT_V(8); PG8_WAIT_L(0); PG8_BAR; PG8_MMA(0, 0, At, B0); PG8_MMA(0, 1, At, B1); PG8_BAR; PG8_SCHED;
            PG8_LDA(At, 1, 1); PG8_STAGE(PG8_SB(1, 0), b3, voffB); PG8_STAGE(PG8_SB(1, 1), b3 + hstep, voffB); PG8_STAGE(PG8_SA(1, 0), a3, voffA);
            PG8_WAIT_V(8); PG8_WAIT_L(0); PG8_BAR; PG8_MMA(1, 0, At, B0); PG8_MMA(1, 1, At, B1); PG8_BAR; PG8_SCHED;
            } else {
            PG8_LDB(B0, 0, 0); PG8_SCHED; PG8_LDA(At, 0, 0); PG8_STAGE(PG8_SA(1, 1), a1 + hstep, voffA);
            PG8_WAIT_L(8); PG8_BAR; PG8_WAIT_L(0); PG8_MMA(0, 0, At, B0); PG8_BAR; PG8_SCHED;
            PG8_LDB(B1, 0, 1); PG8_STAGE(PG8_SB(0, 0), b2, voffB);
            PG8_BAR; PG8_WAIT_L(0); PG8_MMA(0, 1, At, B1); PG8_BAR;
            PG8_LDA(At, 0, 1); PG8_STAGE(PG8_SA(0, 0), a2, voffA);
            PG8_BAR; PG8_WAIT_L(0); PG8_MMA(1, 0, At, B0); PG8_BAR; PG8_SCHED;
            PG8_STAGE(PG8_SB(0, 1), b2 + hstep, voffB);
            PG8_WAIT_V(6); PG8_BAR; PG8_MMA(1, 1, At, B1); PG8_BAR;
            PG8_LDB(B0, 1, 0); PG8_SCHED; PG8_LDA(At, 1, 0); PG8_STAGE(PG8_SA(0, 1), a2 + hstep, voffA);
            PG8_WAIT_L(8); PG8_BAR; PG8_WAIT_L(0); PG8_MMA(0, 0, At, B0); PG8_BAR; PG8_SCHED;
            PG8_LDB(B1, 1, 1); PG8_STAGE(PG8_SB(1, 0), b3, voffB);
            PG8_BAR; PG8_WAIT_L(0); PG8_MMA(0, 1, At, B1); PG8_BAR;
            PG8_LDA(At, 1, 1); PG8_STAGE(PG8_SA(1, 0), a3, voffA);
            PG8_BAR; PG8_WAIT_L(0); PG8_MMA(1, 0, At, B0); PG8_BAR; PG8_SCHED;
            PG8_STAGE(PG8_SB(1, 1), b3 + hstep, voffB);
            PG8_WAIT_V(6); PG8_BAR; PG8_MMA(1, 1, At, B1); PG8_BAR;
            }
        }
        if constexpr (ALIGN_EPI) { if (wr == 0) PG8_BAR; }
        if constexpr (!Epi::AFTER_DRAIN) { E(acc, cur, wr, wc, fr, fq); S.done(cur); }
        if (!has_next) break;
#pragma unroll
        for (int a = 0; a < 2; ++a)
#pragma unroll
            for (int b = 0; b < 2; ++b)
#pragma unroll
                for (int m = 0; m < 4; ++m)
#pragma unroll
                    for (int n = 0; n < 2; ++n) acc[a][b][m][n] = (f32x4){0.f, 0.f, 0.f, 0.f};
        cur = nxt; cA = nA; cB = nB; ++ui;
        if constexpr (ALIGN_EPI) { if (wr == 1) PG8_BAR; }
    }
    PG8_WAIT_V(0);
    if constexpr (!ALIGN_EPI) { if (wr == 0) PG8_BAR; }
    PG8_BAR;
    if constexpr (Epi::AFTER_DRAIN) { E.fused(acc, cur, wr, wc, fr, fq, lds, wid, lane); S.done(cur); }
#undef PG8_SA
#undef PG8_SB
#undef PG8_STAGE
#undef PG8_LDA
#undef PG8_LDB
#undef PG8_MMA
#undef PG8_WAIT_V
#undef PG8_WAIT_L
#undef PG8_BAR
#undef PG8_SCHED
}
}
#ifndef PG8_SP2
#define PG8_SP2 true
#endif
#ifndef PG8_ALIGN
#define PG8_ALIGN true
#endif
#ifndef MK_N_LAUNCHES
#define MK_N_LAUNCHES 1
#endif
constexpr int NWAVES = 8;
constexpr int PER_PHASE = 9;
constexpr int N_LAUNCHES = MK_N_LAUNCHES;

constexpr int BATCH = 4, SEQ = 4096, D = 1024, M = BATCH * SEQ;
constexpr int NQ = 1536, NIN = 7168, FF = 2816, NGU = 2 * FF, PW = 512;
constexpr float NORM_EPS = 1e-6f;
constexpr float QSCALE = 0.125f * 1.4426950408889634f;

constexpr size_t MiB = 1u << 20;
constexpr size_t WS_CTL = 0, CTL_ZERO_BYTES = 64 * 1024;
constexpr size_t WS_CS = 1 * MiB;
constexpr size_t WS_SSQ1 = WS_CS + 256 * 1024, WS_SSQ2 = WS_SSQ1 + 256 * 1024;
constexpr size_t WS_LSE = 2 * MiB;
constexpr size_t WS_WIN = 4 * MiB, WS_WAB = 18 * MiB, WS_WOUT = 20 * MiB, WS_WGU = 22 * MiB, WS_WD = 33 * MiB;
constexpr size_t WS_XN = 40 * MiB;
constexpr size_t WS_PART = 40 * MiB;
constexpr size_t WS_Q = 88 * MiB, WS_K = 136 * MiB, WS_V = 184 * MiB;
constexpr size_t WS_ZZ = 232 * MiB;
constexpr size_t WS_ACAT = 88 * MiB;
constexpr size_t WS_HB = 88 * MiB;
constexpr size_t WS_T1 = 136 * MiB;
constexpr size_t WS_MG = 200 * MiB;
constexpr size_t WS_ACT = 136 * MiB;
constexpr size_t WS_END = 248 * MiB;
static_assert(WS_WIN + (size_t)NIN * D * 2 <= WS_WAB && WS_WAB + (size_t)2048 * 512 * 2 <= WS_WOUT && WS_WOUT + (size_t)D * D * 2 <= WS_WGU && WS_WGU + (size_t)NGU * D * 2 <= WS_WD && WS_WD + (size_t)D * FF * 2 <= WS_XN, "weights map");
static_assert(WS_PART + (size_t)3 * M * 512 * 2 <= WS_Q && WS_Q + (size_t)M * NQ * 2 <= WS_K && WS_K + (size_t)M * NQ * 2 <= WS_V && WS_V + (size_t)M * NQ * 2 <= WS_ZZ && WS_ZZ + (size_t)M * PW * 2 <= WS_END, "activation map");
static_assert(WS_T1 + (size_t)M * D * 4 <= WS_MG && WS_MG + (size_t)M * D * 2 <= WS_ZZ && WS_ACT + (size_t)M * FF * 2 <= WS_ZZ && WS_LSE + (size_t)3 * M * 8 * 4 <= WS_WIN, "overlay map");
constexpr int CW_TMO = 0, CW_CODE = 1, CW_BAR = 4096;

constexpr int RING_OFF = 0, RING_BYTES = 135168;
constexpr int LDSCTL_OFF = RING_BYTES, MISC_OFF = LDSCTL_OFF + 320;
constexpr int LDS_BYTES = 147456;
static_assert(MISC_OFF + 128 <= LDS_BYTES, "LDS map");

#define GAS __attribute__((address_space(1)))
#define LAS __attribute__((address_space(3)))
typedef unsigned short bf16;
typedef unsigned v4u __attribute__((ext_vector_type(4)));
typedef unsigned v2u __attribute__((ext_vector_type(2)));
typedef float f32x4 __attribute__((ext_vector_type(4)));
typedef short bf16x8 __attribute__((ext_vector_type(8)));
typedef GAS unsigned gu32;
typedef GAS unsigned long long gu64;
#define RLX_AGENT __ATOMIC_RELAXED, __HIP_MEMORY_SCOPE_AGENT
#define LDS_WAIT() asm volatile("s_waitcnt lgkmcnt(0)" ::: "memory")
#define VM_WAIT() asm volatile("s_waitcnt vmcnt(0)" ::: "memory")
__device__ __forceinline__ unsigned long long rt() { return __builtin_amdgcn_s_memrealtime(); }
__device__ __forceinline__ unsigned f2bf(float f) { unsigned u = __builtin_bit_cast(unsigned, f); return (u + 0x7fffu + ((u >> 16) & 1u)) >> 16; }
__device__ __forceinline__ unsigned pk2(float lo, float hi) { return f2bf(lo) | (f2bf(hi) << 16); }

#define XB_TMO      128
#define XB_XCNT(j)  (256  + 64 * (j))
#define XB_XSUB(j)  (1280 + 64 * (j))
#define XB_XGEN(j)  (2304 + 64 * (j))
#define XB_TOP      3328
#define XB_TOPGEN   3392
#define XCD_BAR_WORDS 3456
#define XB_SPIN_CAP (1u << 18)

__device__ __forceinline__ unsigned xb_ld(unsigned* p)              { return __hip_atomic_load(p, __ATOMIC_RELAXED, __HIP_MEMORY_SCOPE_AGENT); }
__device__ __forceinline__ unsigned xb_add(unsigned* p, unsigned v) { return __hip_atomic_fetch_add(p, v, __ATOMIC_RELAXED, __HIP_MEMORY_SCOPE_AGENT); }
__device__ __forceinline__ unsigned xb_xcc_id() { return (unsigned)__builtin_amdgcn_s_getreg((3 << 11) | 20) & 0xFu; }
#define XB_SPIN(cond, bar) do { unsigned _sp = 0; while (cond) { __builtin_amdgcn_s_sleep(1); \
    if ((++_sp & 255u) == 0u) { if (xb_ld(&(bar)[XB_TMO])) break; if (_sp > XB_SPIN_CAP) { atomicAdd(&(bar)[XB_TMO], 1u); break; } } } } while (0)

struct XcdBarrier {
    unsigned* bar; unsigned x;
    volatile LAS unsigned* st;
};

__device__ __forceinline__ XcdBarrier xcd_barrier_post(unsigned* bar, volatile LAS unsigned* st) {
    XcdBarrier b; b.bar = bar; b.x = xb_xcc_id(); b.st = st;
    if (threadIdx.x == 0) (void)xb_add(&bar[XB_XCNT(b.x)], 1u);
    return b;
}
__device__ __forceinline__ void xcd_barrier_complete(unsigned* bar, unsigned x, unsigned& nloc, unsigned& nx) {
    const unsigned G = gridDim.x * gridDim.y * gridDim.z;
    unsigned sum, cnt, mine, sp = 0u;
    for (;;) {
        sum = 0u; cnt = 0u; mine = 0u;
#pragma unroll
        for (unsigned j = 0; j < 16; ++j) { const unsigned c = xb_ld(&bar[XB_XCNT(j)]); sum += c; cnt += (c > 0u) ? 1u : 0u; mine = (j == x) ? c : mine; }
        if (sum == G) break;
        __builtin_amdgcn_s_sleep(1);
        if ((++sp & 255u) == 0u) { if (xb_ld(&bar[XB_TMO])) break; if (sp > XB_SPIN_CAP) { atomicAdd(&bar[XB_TMO], 1u); break; } }
    }
    nloc = mine > 0u ? mine : 1u; nx = cnt > 0u ? cnt : 1u;
}

__device__ __forceinline__ void xcd_barrier(const XcdBarrier& b) {
    asm volatile("s_waitcnt vmcnt(0)" ::: "memory");
    __syncthreads();
    if (threadIdx.x == 0) {
        unsigned* bar = b.bar;
        __builtin_amdgcn_s_waitcnt(0);
        unsigned nloc = b.st[0], nx = b.st[1];
        if (nloc == 0u) { xcd_barrier_complete(bar, b.x, nloc, nx); b.st[0] = nloc; b.st[1] = nx; }
        const unsigned old = xb_add(&bar[XB_XSUB(b.x)], 1u);
        const unsigned gen = old / nloc;
        if (old + 1u == (gen + 1u) * nloc) {
            __builtin_amdgcn_fence(__ATOMIC_RELEASE, "agent");
            asm volatile("s_waitcnt vmcnt(0)" ::: "memory");
            const unsigned og = xb_add(&bar[XB_TOP], 1u);
            const unsigned tg = og / nx;
            if (og + 1u == (tg + 1u) * nx) xb_add(&bar[XB_TOPGEN], 1u);
            else XB_SPIN(xb_ld(&bar[XB_TOPGEN]) == tg, bar);
            __builtin_amdgcn_fence(__ATOMIC_ACQUIRE, "agent");
            xb_add(&bar[XB_XGEN(b.x)], 1u);
            asm volatile("s_waitcnt vmcnt(0)" ::: "memory");
        } else {
            XB_SPIN(xb_ld(&bar[XB_XGEN(b.x)]) == gen, bar);
            __builtin_amdgcn_fence(__ATOMIC_ACQUIRE, "agent");
            asm volatile("s_waitcnt vmcnt(0)" ::: "memory");
        }
    }
    __syncthreads();
}

typedef float f32x16 __attribute__((ext_vector_type(16)));
typedef short s16x4 __attribute__((ext_vector_type(4)));
struct Frame {
    LAS unsigned char* lds;
    volatile LAS unsigned* MISC;
    gu32* ctl;
    int tid, lane, wave, vcu, G;
    const float *x, *norm_mix, *w_in, *w_pg, *pool_scale, *w_ab, *w_pb, *w_out, *norm_ffn, *w_gate, *w_up, *w_down, *norm_final;
    float* out;
    unsigned char* ws;
};
#define WSP(T, off) ((T*)(F.ws + (off)))

__device__ __forceinline__ float wave_sum(float v) {
#pragma unroll
    for (int o = 1; o < 64; o <<= 1) v += __shfl_xor(v, o);
    return v;
}
__device__ __forceinline__ void tr_item(const float* W, int ldw, int ncol0, int k0, const float* ksc, bf16* WT, int Kp, int drow0, LAS float* scr, int lane) {
#pragma unroll 8
    for (int i = 0; i < 32; ++i) { const int kk = 2 * i + (lane >> 5); float w = W[(size_t)(k0 + kk) * ldw + ncol0 + (lane & 31)]; if (ksc) w *= ksc[k0 + kk]; scr[kk * 33 + (lane & 31)] = w; }
    LDS_WAIT(); asm volatile("" ::: "memory");
    const int c = lane & 7;
#pragma unroll
    for (int j = 0; j < 4; ++j) { const int n = (lane >> 3) + 8 * j; const LAS float* s = scr + (8 * c) * 33 + n;
        v4u o; o.x = pk2(s[0 * 33], s[1 * 33]); o.y = pk2(s[2 * 33], s[3 * 33]); o.z = pk2(s[4 * 33], s[5 * 33]); o.w = pk2(s[6 * 33], s[7 * 33]);
        *(GAS v4u*)(WT + (size_t)(drow0 + n) * Kp + k0 + 8 * c) = o; }
    LDS_WAIT(); asm volatile("" ::: "memory");
}
__device__ __forceinline__ void p0_prologue(Frame& F) {
    LAS float* scr = (LAS float*)(F.lds + RING_OFF + F.wave * 16384);
    const int gw = F.vcu * NWAVES + F.wave, NGW = F.G * NWAVES, lane = F.lane;
    bf16* Win_t = WSP(bf16, WS_WIN); bf16* Wab_t = WSP(bf16, WS_WAB); bf16* Wout_t = WSP(bf16, WS_WOUT); bf16* Wgu_t = WSP(bf16, WS_WGU); bf16* Wd_t = WSP(bf16, WS_WD);
    constexpr int I0 = 16 * 144, I1 = 16 * 64, I2 = 8 * 32, I3 = 8 * 32, I4 = 16 * 32, I5 = 16 * 88, I6 = 16 * 88, I7 = 44 * 32;
    constexpr int NITEMS = I0 + I1 + I2 + I3 + I4 + I5 + I6 + I7;
    for (int it = gw; it < NITEMS; it += NGW) {
        int r = it;
        if (r < I0) { const int kb = r / 144, nb = r % 144; tr_item(F.w_in, NIN, 32 * nb, 64 * kb, nullptr, Win_t, D, 32 * nb, scr, lane); continue; } r -= I0;
        if (r < I1) { const int kb = r / 64, nb = r % 64; tr_item(F.w_in, NIN, 5120 + 32 * nb, 64 * kb, nullptr, Win_t, D, 5120 + 32 * nb, scr, lane); continue; } r -= I1;
        if (r < I2) { const int kb = r / 32, nb = r % 32; tr_item(F.w_ab, D, 32 * nb, 64 * kb, nullptr, Wab_t, 512, 32 * nb, scr, lane); continue; } r -= I2;
        if (r < I3) { const int kb = r / 32, nb = r % 32; tr_item(F.w_pb, D, 32 * nb, 64 * kb, nullptr, Wab_t, 512, 1024 + 32 * nb, scr, lane); continue; } r -= I3;
        if (r < I4) { const int kb = r / 32, nb = r % 32; tr_item(F.w_out, D, 32 * nb, 64 * kb, nullptr, Wout_t, D, 32 * nb, scr, lane); continue; } r -= I4;
        if (r < I5) { const int kb = r / 88, nb = r % 88, col = 32 * nb; tr_item(F.w_gate, FF, col, 64 * kb, F.norm_ffn, Wgu_t, D, 256 * (col >> 7) + (col & 127), scr, lane); continue; } r -= I5;
        if (r < I6) { const int kb = r / 88, nb = r % 88, col = 32 * nb; tr_item(F.w_up, FF, col, 64 * kb, F.norm_ffn, Wgu_t, D, 256 * (col >> 7) + 128 + (col & 127), scr, lane); continue; } r -= I6;
        { const int kb = r / 32, nb = r % 32; tr_item(F.w_down, D, 32 * nb, 64 * kb, nullptr, Wd_t, FF, 32 * nb, scr, lane); }
    }
    for (int it = gw; it < 512; it += NGW) {
        const int kb = it >> 4, nb = it & 15, k0 = 32 * kb, n0 = 32 * nb, g = n0 >> 7, l31 = lane & 31, hi = lane >> 5;
        const float* ap = F.w_in + (size_t)(k0 + l31) * NIN + 4608 + 128 * g + hi;
        const float* bp = F.w_pg + (size_t)g * 16384 + (size_t)hi * 128 + (n0 & 127) + l31;
        f32x16 acc = {0.f, 0.f, 0.f, 0.f, 0.f, 0.f, 0.f, 0.f, 0.f, 0.f, 0.f, 0.f, 0.f, 0.f, 0.f, 0.f};
#pragma unroll 8
        for (int c = 0; c < 128; c += 2) acc = __builtin_amdgcn_mfma_f32_32x32x2f32(ap[c], bp[(size_t)c * 128], acc, 0, 0, 0);
        const float sc = F.pool_scale[n0 + l31];
        bf16* orow = Win_t + (size_t)(4608 + n0 + l31) * D + k0 + 4 * hi;
#pragma unroll
        for (int q = 0; q < 4; ++q) { v2u o; o.x = pk2(acc[4 * q] * sc, acc[4 * q + 1] * sc); o.y = pk2(acc[4 * q + 2] * sc, acc[4 * q + 3] * sc); *(GAS v2u*)(orow + 8 * q) = o; }
    }
    bf16* XN = WSP(bf16, WS_XN);
    for (int m = gw; m < M; m += NGW) {
        const GAS f32x4* xr = (const GAS f32x4*)(F.x + (size_t)m * D) + lane; const GAS f32x4* gr = (const GAS f32x4*)F.norm_mix + lane;
        f32x4 v[4]; float s = 0.f;
#pragma unroll
        for (int j = 0; j < 4; ++j) { v[j] = xr[64 * j]; s += (v[j].x * v[j].x + v[j].y * v[j].y) + (v[j].z * v[j].z + v[j].w * v[j].w); }
        const float rstd = 1.0f / sqrtf(wave_sum(s) * (1.f / D) + NORM_EPS);
        GAS unsigned long long* o8 = (GAS unsigned long long*)(XN + (size_t)m * D) + lane;
#pragma unroll
        for (int j = 0; j < 4; ++j) { const f32x4 g = gr[64 * j]; o8[64 * j] = (unsigned long long)pk2(v[j].x * rstd * g.x, v[j].y * rstd * g.y) | ((unsigned long long)pk2(v[j].z * rstd * g.z, v[j].w * rstd * g.w) << 32); }
    }
    float* cs = WSP(float, WS_CS);
    for (int e = (F.vcu * NWAVES * 64) + F.tid; e < SEQ * 8; e += F.G * NWAVES * 64) {
        const int pos = e >> 3, i = e & 7;
        const float f = (float)exp2(-(double)i * 0.125 * 18.931568569324174);
        const float ang = (float)pos * f;
        cs[pos * 16 + i] = (float)cos((double)ang); cs[pos * 16 + 8 + i] = (float)sin((double)ang);
    }
}

constexpr int AT_KCH = 385 * 16, AT_VDH = 384 * 64 + 64;
constexpr int AT_K = 0, AT_V = 8 * AT_KCH, AT_WS = AT_V + 2 * AT_VDH, AT_OST = AT_WS + NWAVES * 256, AT_END = AT_OST + NWAVES * 4096;
static_assert(AT_END <= RING_BYTES, "attention LDS");
__device__ __forceinline__ int crow(int r, int hi) { return (r & 3) + 8 * (r >> 2) + 4 * hi; }
__device__ __forceinline__ void attn_unit(Frame& F, int u) {
    const int tid = F.tid, lane = F.lane, wave = F.wave, tl = lane & 31, hi = lane >> 5;
    const int w16 = u & 15, j = (u >> 4) & 7, bg = u >> 7, g = bg % 3, b = bg / 3;
    const int dsh = 2 * g, dm1 = (1 << dsh) - 1, cls = w16 & dm1, C0 = (w16 >> dsh) * 256;
    const size_t rowb = (size_t)b * SEQ; const int hcol = (g * 8 + j) * 64;
    const bf16* Qb = WSP(bf16, WS_Q); const bf16* Kb = WSP(bf16, WS_K); const bf16* Vb = WSP(bf16, WS_V);
    LAS unsigned char* L = F.lds + RING_OFF;
    v4u kreg[6], vreg[6];
#pragma unroll
    for (int it = 0; it < 6; ++it) { const int idx = it * 512 + tid, kl = idx >> 3, c8 = idx & 7; int si = C0 - 128 + kl; si = si < 0 ? 0 : si; const int pos = cls + (si << dsh);
        const size_t off = (rowb + pos) * NQ + hcol + c8 * 8; kreg[it] = *(const GAS v4u*)(Kb + off); vreg[it] = *(const GAS v4u*)(Vb + off); }
    bf16x8 qr[4];
    { const int siq = C0 + 32 * wave + tl, posq = cls + (siq << dsh); const bf16* qp = Qb + (rowb + posq) * NQ + hcol + hi * 8;
#pragma unroll
      for (int ks = 0; ks < 4; ++ks) qr[ks] = *(const GAS bf16x8*)(qp + ks * 16); }
#pragma unroll
    for (int it = 0; it < 6; ++it) { const int idx = it * 512 + tid, kl = idx >> 3, c8 = idx & 7;
        *(LAS v4u*)(L + AT_K + c8 * AT_KCH + kl * 16) = kreg[it];
        *(LAS v4u*)(L + AT_V + (c8 >> 2) * AT_VDH + (kl >> 3) * 512 + (kl & 7) * 64 + (c8 & 3) * 16) = vreg[it]; }
    __syncthreads();
    f32x16 p[5];
#pragma unroll
    for (int kt = 0; kt < 5; ++kt) {
        p[kt] = (f32x16){0.f, 0.f, 0.f, 0.f, 0.f, 0.f, 0.f, 0.f, 0.f, 0.f, 0.f, 0.f, 0.f, 0.f, 0.f, 0.f};
#pragma unroll
        for (int ks = 0; ks < 4; ++ks) { const bf16x8 kf = *(const LAS bf16x8*)(L + AT_K + (2 * ks + hi) * AT_KCH + (32 * (wave + kt) + tl) * 16);
            p[kt] = __builtin_amdgcn_mfma_f32_32x32x16_bf16(kf, qr[ks], p[kt], 0, 0, 0); }
    }
    const int kmin = 128 - C0 - 32 * wave;
    float mx = -1e30f;
#pragma unroll
    for (int kt = 0; kt < 5; ++kt)
#pragma unroll
        for (int r = 0; r < 16; ++r) { const int kk = 32 * kt + crow(r, hi), df = 128 + tl - kk; const bool ok = (df >= 0) && (df <= 128) && (kk >= kmin);
            const float s = ok ? p[kt][r] : -1e30f; p[kt][r] = s; mx = fmaxf(mx, s); }
    mx = fmaxf(mx, __shfl_xor(mx, 32));
    float l = 0.f;
#pragma unroll
    for (int kt = 0; kt < 5; ++kt)
#pragma unroll
        for (int r = 0; r < 16; ++r) { const float e = __builtin_amdgcn_exp2f(p[kt][r] - mx); p[kt][r] = e; l += e; }
    l += __shfl_xor(l, 32);
    f32x16 o[2];
    o[0] = (f32x16){0.f, 0.f, 0.f, 0.f, 0.f, 0.f, 0.f, 0.f, 0.f, 0.f, 0.f, 0.f, 0.f, 0.f, 0.f, 0.f}; o[1] = o[0];
    const int vlane = (4 * hi + ((lane & 15) >> 2)) * 64 + ((lane >> 4) & 1) * 32 + (lane & 3) * 8;
#pragma unroll
    for (int kt = 0; kt < 5; ++kt)
#pragma unroll
        for (int s2 = 0; s2 < 2; ++s2) {
            v4u pw; pw.x = pg8::cvt_pk_bf16(p[kt][8 * s2 + 0], p[kt][8 * s2 + 1]); pw.y = pg8::cvt_pk_bf16(p[kt][8 * s2 + 2], p[kt][8 * s2 + 3]);
            pw.z = pg8::cvt_pk_bf16(p[kt][8 * s2 + 4], p[kt][8 * s2 + 5]); pw.w = pg8::cvt_pk_bf16(p[kt][8 * s2 + 6], p[kt][8 * s2 + 7]);
            const bf16x8 pa = __builtin_bit_cast(bf16x8, pw);
#pragma unroll
            for (int dh = 0; dh < 2; ++dh) {
                LAS unsigned char* vp = L + AT_V + dh * AT_VDH + (32 * (wave + kt) + 16 * s2) * 64 + vlane;
                const s16x4 lo = __builtin_bit_cast(s16x4, __builtin_amdgcn_ds_read_tr16_b64_v4i16((LAS s16x4*)vp));
                const s16x4 hh = __builtin_bit_cast(s16x4, __builtin_amdgcn_ds_read_tr16_b64_v4i16((LAS s16x4*)(vp + 512)));
                const bf16x8 vf = (bf16x8){lo[0], lo[1], lo[2], lo[3], hh[0], hh[1], hh[2], hh[3]};
                o[dh] = __builtin_amdgcn_mfma_f32_32x32x16_bf16(pa, vf, o[dh], 0, 0, 0);
            }
        }
    LAS float* wsf = (LAS float*)(L + AT_WS + wave * 256);
    if (hi == 0) wsf[tl] = l;
    LDS_WAIT(); asm volatile("" ::: "memory");
    LAS unsigned short* stg = (LAS unsigned short*)(L + AT_OST + wave * 4096);
#pragma unroll
    for (int r = 0; r < 16; ++r) { const int orow = crow(r, hi); const float rl = __builtin_amdgcn_rcpf(wsf[orow]);
#pragma unroll
        for (int dh = 0; dh < 2; ++dh) stg[orow * 64 + dh * 32 + tl] = (unsigned short)f2bf(o[dh][r] * rl); }
    LDS_WAIT(); asm volatile("" ::: "memory");
    bf16* PART = WSP(bf16, WS_PART) + (size_t)g * M * 512; float* LSE = WSP(float, WS_LSE) + (size_t)g * M * 8;
#pragma unroll
    for (int i = 0; i < 4; ++i) { const int row = i * 8 + (lane >> 3), ch = lane & 7; const v4u v = *(const LAS v4u*)(stg + row * 64 + ch * 8);
        const int pos = cls + ((C0 + 32 * wave + row) << dsh); *(GAS v4u*)(PART + (rowb + pos) * 512 + j * 64 + ch * 8) = v; }
    if (hi == 0) { const int pos = cls + ((C0 + 32 * wave + tl) << dsh); LSE[(rowb + pos) * 8 + j] = mx + __builtin_amdgcn_logf(l); }
    __syncthreads();
}

__device__ __forceinline__ void unpack8f(const v4u w, float (&f)[8]) {
    f[0] = __uint_as_float(w.x << 16); f[1] = __uint_as_float(w.x & 0xffff0000u); f[2] = __uint_as_float(w.y << 16); f[3] = __uint_as_float(w.y & 0xffff0000u);
    f[4] = __uint_as_float(w.z << 16); f[5] = __uint_as_float(w.z & 0xffff0000u); f[6] = __uint_as_float(w.w << 16); f[7] = __uint_as_float(w.w & 0xffff0000u); }
__device__ __forceinline__ void p2b_phase(Frame& F) {
    const int gw = F.vcu * NWAVES + F.wave, NGW = F.G * NWAVES, lane = F.lane;
    const bf16* PART = WSP(bf16, WS_PART); const float* LSE = WSP(float, WS_LSE); const bf16* ZZ = WSP(bf16, WS_ZZ); bf16* ACAT = WSP(bf16, WS_ACAT);
    const int jh = lane >> 3, gp = lane >> 4, wnd = 2 << gp;
    for (int tok = gw; tok < M; tok += NGW) {
        const float l0 = LSE[(size_t)tok * 8 + jh], l1 = LSE[((size_t)M + tok) * 8 + jh], l2 = LSE[((size_t)2 * M + tok) * 8 + jh];
        const float mm = fmaxf(fmaxf(l0, l1), l2);
        const float w0 = __builtin_amdgcn_exp2f(l0 - mm), w1 = __builtin_amdgcn_exp2f(l1 - mm), w2 = __builtin_amdgcn_exp2f(l2 - mm);
        const float inv = 1.0f / (w0 + w1 + w2);
        float a0[8], a1[8], a2[8];
        unpack8f(*(const GAS v4u*)(PART + (size_t)tok * 512 + 8 * lane), a0);
        unpack8f(*(const GAS v4u*)(PART + ((size_t)M + tok) * 512 + 8 * lane), a1);
        unpack8f(*(const GAS v4u*)(PART + ((size_t)2 * M + tok) * 512 + 8 * lane), a2);
        float r[8];
#pragma unroll
        for (int e = 0; e < 8; ++e) r[e] = (w0 * a0[e] + w1 * a1[e] + w2 * a2[e]) * inv;
        v4u o; o.x = pk2(r[0], r[1]); o.y = pk2(r[2], r[3]); o.z = pk2(r[4], r[5]); o.w = pk2(r[6], r[7]);
        *(GAS v4u*)(ACAT + (size_t)tok * 512 + 8 * lane) = o;
        const int pos = tok & (SEQ - 1); const int cnt = (pos + 1) < wnd ? (pos + 1) : wnd;
        float own[8], sum[8];
        unpack8f(*(const GAS v4u*)(ZZ + (size_t)tok * 512 + 8 * lane), own);
#pragma unroll
        for (int e = 0; e < 8; ++e) sum[e] = own[e];
        for (int i = 1; i < 16; ++i) { if (i < cnt) { float t[8]; unpack8f(*(const GAS v4u*)(ZZ + (size_t)(tok - i) * 512 + 8 * lane), t);
#pragma unroll
                for (int e = 0; e < 8; ++e) sum[e] += t[e]; } }
        const float rc = 1.0f / (float)cnt;
#pragma unroll
        for (int e = 0; e < 8; ++e) r[e] = sum[e] * rc - own[e];
        o.x = pk2(r[0], r[1]); o.y = pk2(r[2], r[3]); o.z = pk2(r[4], r[5]); o.w = pk2(r[6], r[7]);
        *(GAS v4u*)(ACAT + ((size_t)M + tok) * 512 + 8 * lane) = o;
    }
}
__device__ __forceinline__ void p7_phase(Frame& F) {
    const int gw = F.vcu * NWAVES + F.wave, NGW = F.G * NWAVES, lane = F.lane; const float* SSQ = WSP(float, WS_SSQ2);
    const GAS f32x4* gr = (const GAS f32x4*)F.norm_final + lane;
    for (int m = gw; m < M; m += NGW) {
        const f32x4 s = *(const GAS f32x4*)(SSQ + (size_t)m * 4);
        const float rstd = 1.0f / sqrtf(((s.x + s.y) + (s.z + s.w)) * (1.f / D) + NORM_EPS);
        GAS f32x4* xr = (GAS f32x4*)(F.out + (size_t)m * D) + lane;
#pragma unroll
        for (int j = 0; j < 4; ++j) { const f32x4 v = xr[64 * j], g = gr[64 * j]; xr[64 * j] = (v * rstd) * g; }
    }
}

struct Args { const float* in[13]; float* out; unsigned char* ws; int ph_lo, ph_hi, li, pad; };
__global__ void __launch_bounds__(NWAVES * 64, 2) mega_fwd(Args args) {
    extern __shared__ __attribute__((aligned(16))) unsigned char lds[];
    Frame F;
    F.lds = (LAS unsigned char*)lds;
    F.MISC = (volatile LAS unsigned*)(F.lds + MISC_OFF);
    F.tid = threadIdx.x; F.lane = F.tid & 63; F.wave = __builtin_amdgcn_readfirstlane(F.tid >> 6);
    F.G = gridDim.x; { const int bx = blockIdx.x; F.vcu = (F.G % 8 == 0) ? (bx % 8) * (F.G / 8) + bx / 8 : bx; }
    F.ws = args.ws; F.ctl = (gu32*)(args.ws + WS_CTL); F.out = args.out;
    F.x = args.in[0]; F.norm_mix = args.in[1]; F.w_in = args.in[2]; F.w_pg = args.in[3]; F.pool_scale = args.in[4]; F.w_ab = args.in[5]; F.w_pb = args.in[6];
    F.w_out = args.in[7]; F.norm_ffn = args.in[8]; F.w_gate = args.in[9]; F.w_up = args.in[10]; F.w_down = args.in[11]; F.norm_final = args.in[12];
    for (int u = F.tid; u < (LDS_BYTES - LDSCTL_OFF) / 4; u += NWAVES * 64) ((LAS unsigned*)(F.lds + LDSCTL_OFF))[u] = 0u;
    __syncthreads();
    XcdBarrier bar; bar.bar = (unsigned*)(F.ctl + CW_BAR); bar.x = 0; bar.st = nullptr;
    if (N_LAUNCHES == 1) bar = xcd_barrier_post((unsigned*)(F.ctl + CW_BAR), F.MISC + 8);
#define GRID_BAR() do { if (N_LAUNCHES == 1) xcd_barrier(bar); } while (0)
    const int lo = args.ph_lo, hi = args.ph_hi;
#define IN(k) (lo <= (k) && (k) < hi)
#define BOTH(k) (IN(k) && IN((k) + 1))
    using pg8::Gemm; using pg8::StaticOrder; using pg8::P3Order; using pg8::EpiP1; using pg8::EpiP3; using pg8::EpiRes; using pg8::EpiP5; using pg8::gemm_phase; using pg8::bf16_t;
    bf16_t* const Win_t = WSP(bf16_t, WS_WIN); bf16_t* const Wab_t = WSP(bf16_t, WS_WAB); bf16_t* const Wout_t = WSP(bf16_t, WS_WOUT); bf16_t* const Wgu_t = WSP(bf16_t, WS_WGU); bf16_t* const Wd_t = WSP(bf16_t, WS_WD);
    bf16_t* const GA = (bf16_t*)args.out; bf16_t* const GP = GA + (size_t)M * D;

    if (IN(0)) { p0_prologue(F); if (BOTH(0)) GRID_BAR(); }
    if (IN(1)) {
        Gemm g{WSP(bf16_t, WS_XN), Win_t, M, NIN, D}; StaticOrder S; S.init(M, NIN, F.G, (int)blockIdx.x);
        EpiP1 E{WSP(bf16_t, WS_Q), WSP(bf16_t, WS_K), WSP(bf16_t, WS_V), WSP(bf16_t, WS_ZZ), GA, GP, WSP(float, WS_CS), QSCALE};
        gemm_phase<EpiP1, StaticOrder, PG8_ALIGN, PG8_SP2>(F.lds + RING_OFF, g, S, E);
        if (BOTH(1)) GRID_BAR();
    }
    if (IN(2)) {
        for (int u = F.vcu; u < BATCH * 3 * 8 * 16; u += F.G) attn_unit(F, u);
        if (BOTH(2)) GRID_BAR();
    }
    if (IN(3)) { p2b_phase(F); if (BOTH(3)) GRID_BAR(); }
    if (IN(4)) {
        Gemm g{WSP(bf16_t, WS_ACAT), Wab_t, 2 * M, 2048, 512}; P3Order S; S.so.init(M, D, F.G, (int)blockIdx.x);
        EpiP3 E{GA, GP, WSP(float, WS_T1), WSP(bf16_t, WS_MG)};
        gemm_phase<EpiP3, P3Order, PG8_ALIGN, PG8_SP2>(F.lds + RING_OFF, g, S, E);
        if (BOTH(4)) GRID_BAR();
    }
    if (IN(5)) {
        Gemm g{WSP(bf16_t, WS_MG), Wout_t, M, D, D}; StaticOrder S; S.init(M, D, F.G, (int)blockIdx.x);
        EpiRes<true> E{F.x, F.out, WSP(bf16_t, WS_HB), WSP(float, WS_SSQ1)};
        gemm_phase<EpiRes<true>, StaticOrder, false, PG8_SP2>(F.lds + RING_OFF, g, S, E);
        if (BOTH(5)) GRID_BAR();
    }
    if (IN(6)) {
        Gemm g{WSP(bf16_t, WS_HB), Wgu_t, M, NGU, D}; StaticOrder S; S.init(M, NGU, F.G, (int)blockIdx.x);
        EpiP5 E{WSP(float, WS_SSQ1), WSP(bf16_t, WS_ACT), NORM_EPS};
        gemm_phase<EpiP5, StaticOrder, PG8_ALIGN, PG8_SP2>(F.lds + RING_OFF, g, S, E);
        if (BOTH(6)) GRID_BAR();
    }
    if (IN(7)) {
        Gemm g{WSP(bf16_t, WS_ACT), Wd_t, M, D, FF}; StaticOrder S; S.init(M, D, F.G, (int)blockIdx.x);
        EpiRes<false> E{F.out, F.out, nullptr, WSP(float, WS_SSQ2)};
        gemm_phase<EpiRes<false>, StaticOrder, false, PG8_SP2>(F.lds + RING_OFF, g, S, E);
        if (BOTH(7)) GRID_BAR();
    }
    if (IN(8)) p7_phase(F);
#undef IN
#undef BOTH
}

extern "C" void kernel_launch(void* const* d_in, const int* in_sizes, int n_in, void* d_out, int out_size, void* d_ws, size_t ws_size, hipStream_t stream) {
    static int grid = 0;
    if (grid == 0) {
        if (n_in != 13 || in_sizes[0] != M * D || out_size != M * D || ws_size < WS_END) { fprintf(stderr, "kernel_launch: unexpected shapes (n_in %d, in0 %d, out %d, ws %zu)\n", n_in, n_in > 0 ? in_sizes[0] : -1, out_size, ws_size); grid = -1; return; }
        int dev = 0, cus = 0, per_cu = 0;
        if (hipGetDevice(&dev) != hipSuccess || hipDeviceGetAttribute(&cus, hipDeviceAttributeMultiprocessorCount, dev) != hipSuccess) { grid = -1; return; }
        if (hipFuncSetAttribute((const void*)mega_fwd, hipFuncAttributeMaxDynamicSharedMemorySize, LDS_BYTES) != hipSuccess) { fprintf(stderr, "kernel_launch: hipFuncSetAttribute failed\n"); grid = -1; return; }
        if (hipOccupancyMaxActiveBlocksPerMultiprocessor(&per_cu, (const void*)mega_fwd, NWAVES * 64, LDS_BYTES) != hipSuccess || per_cu < 1) { fprintf(stderr, "kernel_launch: occupancy query says %d blocks per CU\n", per_cu); }
        (void)hipGetLastError();
        grid = cus;
        if (grid != 256) fprintf(stderr, "kernel_launch: %d CUs; this build is laid out for 256\n", grid);
    }
    if (grid < 0) return;
    (void)hipMemsetAsync((char*)d_ws + WS_CTL, 0, CTL_ZERO_BYTES, stream);
    Args a{};
    for (int i = 0; i < 13; ++i) a.in[i] = (const float*)d_in[i];
    a.out = (float*)d_out; a.ws = (unsigned char*)d_ws;
    for (int li = 0; li < N_LAUNCHES; ++li) {
        a.ph_lo = (N_LAUNCHES == 1) ? 0 : li; a.ph_hi = (N_LAUNCHES == 1) ? PER_PHASE : li + 1; a.li = li;
        hipLaunchKernelGGL(mega_fwd, dim3(grid), dim3(NWAVES * 64), LDS_BYTES, stream, a);
    }
}
```
